# Optimizing an MI355X kernel written in HIP

```python
import jax, jax.numpy as jnp
from jax import lax
import numpy as np

D_MODEL = 1024
BATCH = 2
SEQ = 16384
DEPTH = 2
DEC_BATCH = 16
DEC_SEQ = 32
PAST_LEN = 4096

CHUNK = 64
N_MIXERS = 2
N_LRU_LAYERS = (DEPTH + 1) // 2
N_FOX_LAYERS = DEPTH // 2
LRU_WIDTH = 3 * D_MODEL // 2
LRU_BLOCKS = 12
LRU_BLOCK_W = LRU_WIDTH // LRU_BLOCKS
CONV_W = 4
LRU_C = 8.0
FOX_HEADS = 16
FOX_HEAD_DIM = D_MODEL // FOX_HEADS
FOX_WIDTH = FOX_HEADS * FOX_HEAD_DIM
FOX_SCALE = FOX_HEAD_DIM ** -0.5
Q_BLOCK = 128
EPS = 1e-6

kernel_name = "hybrid_rglru_fox_stream_step"


def _rmsnorm(x, g):
    xf = x.astype(jnp.float32)
    y = xf * lax.rsqrt(jnp.mean(xf * xf, axis=-1, keepdims=True) + EPS)
    return (y * g.astype(jnp.float32)).astype(x.dtype)


def _adaln(c, w, b):
    mod = jax.nn.silu(c) @ w + b
    shift, scale, gate = jnp.split(mod[:, None, :], 3, axis=-1)
    return shift, scale, gate


def _lru_combine(e1, e2):
    a1, b1 = e1
    a2, b2 = e2
    return a1 * a2, a2 * b1 + b2


def _rglru_branch(h, conv_buf, h0, w_in, conv_w, conv_b, w_a, b_a, w_x, b_x, lam, w_out):
    B, T, _ = h.shape
    xb, gate = jnp.split(h @ w_in, 2, axis=-1)
    xp = jnp.concatenate([conv_buf.astype(xb.dtype), xb], axis=1)
    xc = conv_b + xp[:, 0:T] * conv_w[0]
    for k in range(1, CONV_W):
        xc = xc + xp[:, k:k + T] * conv_w[k]
    xblk = xc.reshape(B, T, LRU_BLOCKS, LRU_BLOCK_W)
    r = jax.nn.sigmoid(jnp.einsum("btnd,nde->btne", xblk, w_a).reshape(B, T, LRU_WIDTH) + b_a)
    ig = jax.nn.sigmoid(jnp.einsum("btnd,nde->btne", xblk, w_x).reshape(B, T, LRU_WIDTH) + b_x)
    log_a = -LRU_C * r.astype(jnp.float32) * jax.nn.softplus(-lam.astype(jnp.float32))
    a = jnp.exp(log_a)
    u = jnp.sqrt(-jnp.expm1(2.0 * log_a)) * (ig * xc).astype(jnp.float32)
    a_cum, u_cum = lax.associative_scan(_lru_combine, (a, u), axis=1)
    hs = a_cum * h0[:, None, :].astype(jnp.float32) + u_cum
    y = (hs.astype(h.dtype) * jax.nn.silu(gate)) @ w_out
    return y, xp[:, T:], hs[:, -1]


def _fox_attend_block(q, cq, qpos, k, v, ck, kpos):
    s = jnp.einsum("bqhd,bkhd->bhqk", q, k).astype(jnp.float32) * FOX_SCALE
    s = s + jnp.swapaxes(cq, 1, 2)[..., :, None] - jnp.swapaxes(ck, 1, 2)[..., None, :]
    s = jnp.where(kpos[None, None, None, :] <= qpos[None, None, :, None], s, -jnp.inf)
    p = jax.nn.softmax(s, axis=-1)
    return jnp.einsum("bhqk,bkhd->bqhd", p.astype(v.dtype), v)


def _fox_branch(h, past_k, past_v, past_lf, w_in, b_f, w_out):
    B, T, _ = h.shape
    P = past_k.shape[1]
    W = FOX_WIDTH
    q, k, v, g, fl = jnp.split(h @ w_in, [W, 2 * W, 3 * W, 4 * W], axis=-1)
    q = q.reshape(B, T, FOX_HEADS, FOX_HEAD_DIM)
    k = k.reshape(B, T, FOX_HEADS, FOX_HEAD_DIM)
    v = v.reshape(B, T, FOX_HEADS, FOX_HEAD_DIM)
    log_f = jax.nn.log_sigmoid(fl.astype(jnp.float32) + b_f.astype(jnp.float32))
    k_all = jnp.concatenate([past_k.astype(k.dtype), k], axis=1)
    v_all = jnp.concatenate([past_v.astype(v.dtype), v], axis=1)
    cum = jnp.cumsum(jnp.concatenate([past_lf.astype(jnp.float32), log_f], axis=1), axis=1)
    kpos = jnp.arange(P + T)
    qb = Q_BLOCK if T % Q_BLOCK == 0 else T
    nb = T // qb
    qs = jnp.swapaxes(q.reshape(B, nb, qb, FOX_HEADS, FOX_HEAD_DIM), 0, 1)
    cqs = jnp.swapaxes(cum[:, P:].reshape(B, nb, qb, FOX_HEADS), 0, 1)
    qposs = (P + jnp.arange(T)).reshape(nb, qb)
    o = lax.map(lambda blk: _fox_attend_block(blk[0], blk[1], blk[2], k_all, v_all, cum, kpos),
                (qs, cqs, qposs))
    o = jnp.swapaxes(o, 0, 1).reshape(B, T, W)
    y = (o * jax.nn.silu(g)) @ w_out
    return y, k, v, log_f


def setup_inputs(seed: int = 0) -> dict:
    key = jax.random.key(seed)
    ks = jax.random.split(key, 32)
    f32 = jnp.float32
    R, W, H, dh = LRU_WIDTH, FOX_WIDTH, FOX_HEADS, FOX_HEAD_DIM
    NA, NF = N_LRU_LAYERS, N_FOX_LAYERS

    def nrm(k, shape, s):
        return s * jax.random.normal(k, shape, f32)

    a0 = jax.random.uniform(ks[20], (NA, R), f32, 0.9, 0.999) ** (1.0 / LRU_C)
    lru_lambda = jnp.log(a0) - jnp.log1p(-a0)
    return {
        "x_prompt": nrm(ks[0], (BATCH, SEQ, D_MODEL), 1.0),
        "x_sample": nrm(ks[1], (DEC_BATCH, DEC_SEQ, D_MODEL), 1.0),
        "c_prompt": nrm(ks[2], (BATCH, D_MODEL), 1.0),
        "c_sample": nrm(ks[3], (DEC_BATCH, D_MODEL), 1.0),
        "state_lru_h": nrm(ks[4], (NA, DEC_BATCH, R), 0.5),
        "state_lru_conv": nrm(ks[5], (NA, DEC_BATCH, CONV_W - 1, R), 1.0),
        "cache_fox_k": nrm(ks[6], (NF, DEC_BATCH, PAST_LEN, H, dh), 1.0),
        "cache_fox_v": nrm(ks[7], (NF, DEC_BATCH, PAST_LEN, H, dh), 1.0),
        "cache_fox_logf": jax.nn.log_sigmoid(3.0 + jax.random.normal(ks[8], (NF, DEC_BATCH, PAST_LEN, H), f32)),
        "norm_pre": 1.0 + nrm(ks[9], (DEPTH, D_MODEL), 0.05),
        "norm_post": 1.0 + nrm(ks[10], (DEPTH, D_MODEL), 0.05),
        "ada_w": nrm(ks[11], (DEPTH, D_MODEL, 3 * D_MODEL), 0.5 * D_MODEL ** -0.5),
        "ada_b": nrm(ks[12], (DEPTH, 3 * D_MODEL), 0.01),
        "lru_w_in": nrm(ks[13], (NA, D_MODEL, 2 * R), D_MODEL ** -0.5),
        "lru_conv_w": nrm(ks[14], (NA, CONV_W, R), CONV_W ** -0.5),
        "lru_conv_b": nrm(ks[15], (NA, R), 0.01),
        "lru_w_a": nrm(ks[16], (NA, LRU_BLOCKS, LRU_BLOCK_W, LRU_BLOCK_W), LRU_BLOCK_W ** -0.5),
        "lru_b_a": nrm(ks[17], (NA, R), 0.01),
        "lru_w_x": nrm(ks[18], (NA, LRU_BLOCKS, LRU_BLOCK_W, LRU_BLOCK_W), LRU_BLOCK_W ** -0.5),
        "lru_b_x": nrm(ks[19], (NA, R), 0.01),
        "lru_lambda": lru_lambda,
        "lru_w_out": nrm(ks[21], (NA, R, D_MODEL), R ** -0.5),
        "fox_w_in": nrm(ks[22], (NF, D_MODEL, 4 * W + H), D_MODEL ** -0.5),
        "fox_b_f": jax.random.uniform(ks[23], (NF, H), f32, 2.0, 5.0),
        "fox_w_out": nrm(ks[24], (NF, W, D_MODEL), W ** -0.5),
    }


def reference(x_prompt, x_sample, c_prompt, c_sample, state_lru_h, state_lru_conv,
              cache_fox_k, cache_fox_v, cache_fox_logf, norm_pre, norm_post, ada_w, ada_b,
              lru_w_in, lru_conv_w, lru_conv_b, lru_w_a, lru_b_a, lru_w_x, lru_b_x,
              lru_lambda, lru_w_out, fox_w_in, fox_b_f, fox_w_out):
    B = x_prompt.shape[0]
    xp, xs = x_prompt, x_sample
    lru_h_p, lru_c_p, lru_h_s, lru_c_s = [], [], [], []
    fk_p, fv_p, ff_p, fk_s, fv_s, ff_s = [], [], [], [], [], []
    for i in range(DEPTH):
        j = i // N_MIXERS
        sh_p, sc_p, gt_p = _adaln(c_prompt, ada_w[i], ada_b[i])
        sh_s, sc_s, gt_s = _adaln(c_sample, ada_w[i], ada_b[i])
        hp = _rmsnorm(xp, norm_pre[i]) * (1.0 + sc_p) + sh_p
        hs = _rmsnorm(xs, norm_pre[i]) * (1.0 + sc_s) + sh_s
        if i % N_MIXERS == 0:
            lw = (lru_w_in[j], lru_conv_w[j], lru_conv_b[j], lru_w_a[j], lru_b_a[j],
                  lru_w_x[j], lru_b_x[j], lru_lambda[j], lru_w_out[j])
            yp, cbp, hlp = _rglru_branch(hp, jnp.zeros((B, CONV_W - 1, LRU_WIDTH), hp.dtype),
                                         jnp.zeros((B, LRU_WIDTH), jnp.float32), *lw)
            ys, cbs, hls = _rglru_branch(hs, state_lru_conv[j], state_lru_h[j], *lw)
            lru_h_p.append(hlp)
            lru_c_p.append(cbp)
            lru_h_s.append(hls)
            lru_c_s.append(cbs)
        else:
            fw = (fox_w_in[j], fox_b_f[j], fox_w_out[j])
            yp, kp, vp, lfp = _fox_branch(
                hp, jnp.zeros((B, 0, FOX_HEADS, FOX_HEAD_DIM), hp.dtype),
                jnp.zeros((B, 0, FOX_HEADS, FOX_HEAD_DIM), hp.dtype),
                jnp.zeros((B, 0, FOX_HEADS), jnp.float32), *fw)
            ys, ksn, vsn, lfs = _fox_branch(hs, cache_fox_k[j], cache_fox_v[j], cache_fox_logf[j], *fw)
            fk_p.append(kp)
            fv_p.append(vp)
            ff_p.append(lfp)
            fk_s.append(ksn)
            fv_s.append(vsn)
            ff_s.append(lfs)
        xp = xp + gt_p * _rmsnorm(yp, norm_post[i])
        xs = xs + gt_s * _rmsnorm(ys, norm_post[i])
    return (xp, xs,
            jnp.stack(lru_h_p), jnp.stack(lru_c_p), jnp.stack(fk_p), jnp.stack(fv_p), jnp.stack(ff_p),
            jnp.stack(lru_h_s), jnp.stack(lru_c_s), jnp.stack(fk_s), jnp.stack(fv_s), jnp.stack(ff_s))
```

```cpp
#include <hip/hip_runtime.h>
#include <hip/hip_cooperative_groups.h>
#include <hip/hip_bf16.h>
#include <cstdio>
#include <cstdint>
#include <cmath>
namespace cg = cooperative_groups;

constexpr int DM_ = 1024, RW = 1536, TP = 16384, MP = 32768, MS = 512, MT = MP + MS;
constexpr int NSEQ = 18;
constexpr int PAST = 4096, DSQ = 32;
constexpr float EPS_ = 1e-6f;
constexpr float LOG2E = 1.4426950408889634f;
constexpr size_t O_YP = 0, O_YS = 33554432, O_LHP = 34078720, O_LCP = 34081792, O_KP = 34091008, O_VP = 67645440, O_LFP = 101199872,
                 O_LHS = 101724160, O_LCS = 101748736, O_KS = 101822464, O_VS = 102346752, O_LFS = 102871040;
constexpr size_t MiB = 1u << 20;
constexpr size_t WS_MODP = 1 * MiB;
constexpr size_t WS_MOD = 9 * MiB;
constexpr size_t WS_SP2 = 10 * MiB;
constexpr size_t WS_SSQ = 11 * MiB;
constexpr size_t WS_LFW = 14 * MiB;
constexpr size_t WS_BETA = 17 * MiB;
constexpr size_t WS_CA = 20 * MiB, WS_CU = 22 * MiB, WS_CIN = 24 * MiB;
constexpr size_t WS_W0IN = 26 * MiB;
constexpr size_t WS_W0OUT = 32 * MiB;
constexpr size_t WS_W1IN = 35 * MiB;
constexpr size_t WS_W1OUT = 44 * MiB;
constexpr size_t WS_WG = 46 * MiB;
constexpr size_t WS_H = 64 * MiB;
constexpr size_t WS_X1 = 136 * MiB;
constexpr size_t WS_Y = 276 * MiB;
constexpr size_t WS_XBG = 416 * MiB;
constexpr size_t WS_LAU = 624 * MiB;
constexpr size_t WS_XC = 832 * MiB;
constexpr size_t WS_Q = 416 * MiB, WS_K = 488 * MiB, WS_V = 560 * MiB, WS_SG = 632 * MiB;
constexpr size_t WS_END = 936 * MiB;
constexpr int LDS_BYTES = 155648;

#define LAS __attribute__((address_space(3)))
typedef unsigned short bf16r;
typedef float f32x4 __attribute__((ext_vector_type(4)));
typedef float f32x2 __attribute__((ext_vector_type(2)));
typedef unsigned u32x4 __attribute__((ext_vector_type(4)));
typedef unsigned u32x2 __attribute__((ext_vector_type(2)));

__device__ __forceinline__ unsigned cvtpk(float lo, float hi) { unsigned r; asm volatile("v_cvt_pk_bf16_f32 %0, %1, %2" : "=v"(r) : "v"(lo), "v"(hi)); return r; }
__device__ __forceinline__ float bflo(unsigned w) { return __uint_as_float(w << 16); }
__device__ __forceinline__ float bfhi(unsigned w) { return __uint_as_float(w & 0xffff0000u); }
__device__ __forceinline__ float fexp2(float x) { return __builtin_amdgcn_exp2f(x); }
__device__ __forceinline__ float frcp(float x) { return __builtin_amdgcn_rcpf(x); }
__device__ __forceinline__ float sigmoidf_(float x) { return frcp(1.0f + fexp2(-x * LOG2E)); }
__device__ __forceinline__ float siluf_(float x) { return x * sigmoidf_(x); }
__device__ __forceinline__ float wave_sum(float v) {
#pragma unroll
    for (int o = 1; o < 64; o <<= 1) v += __shfl_xor(v, o);
    return v;
}

namespace pg8 {
#define PG8_LAS __attribute__((address_space(3)))
typedef unsigned short bf16_t;
typedef short bf16x8 __attribute__((ext_vector_type(8)));
typedef float f32x4 __attribute__((ext_vector_type(4)));
typedef unsigned u32x4 __attribute__((ext_vector_type(4)));
constexpr int BM = 256, BK = 64, HALF = 128, HTB = HALF * BK * 2  , STAGE_BYTES = 8 * HTB, NXCD = 8, WGM = 8;

__host__ __device__ __forceinline__ int lds_byte(int r, int c) { const int st = (r >> 4) * 2 + (c >> 5), rr = r & 15, cc = c & 31, ob = rr * 64 + cc * 2; return st * 1024 + (ob ^ (((ob >> 9) & 1) << 5)); }
__host__ __device__ __forceinline__ void stage_rc(int b, int& R, int& C) { const int st = b / 1024, sb = b % 1024, swz = sb ^ (((sb >> 9) & 1) << 5); R = (st >> 1) * 16 + swz / 64; C = (st & 1) * 32 + (swz % 64) / 2; }
__host__ __device__ __forceinline__ int perm32(int rho) { const int n = rho >> 4, i = rho & 15; return 8 * (i >> 2) + 4 * n + (i & 3); }

struct Unit { int pm, pn; };
struct Gemm { const bf16_t* A; const bf16_t* Bt; int M, N, K, lda, ldb, a_pn_off; };

struct StaticOrder {
    int nM, nN, nwg, G, c;
    __host__ __device__ void init(int M, int N, int G_, int c_) { nM = M / BM; nN = N / BM; nwg = nM * nN; G = G_; c = c_; }
    __host__ __device__ bool next(int i, Unit& u) const {
        const long L = (long)i * G + c; if (L >= nwg) return false;
        int wgid = (int)L; { const int q = nwg / NXCD, r = nwg % NXCD, xcd = wgid % NXCD, off = wgid / NXCD; wgid = (xcd < r ? xcd * (q + 1) : r * (q + 1) + (xcd - r) * q) + off; }
        const int nig = WGM * nN, gid = wgid / nig, fm = gid * WGM, gsz = (nM - fm) < WGM ? (nM - fm) : WGM;
        u.pm = fm + ((wgid % nig) % gsz); u.pn = (wgid % nig) / gsz; return true;
    }
    __device__ __forceinline__ void a_ready(const Unit&) const {}
    __device__ __forceinline__ void done(const Unit&) const {}
};

__device__ __forceinline__ unsigned cvt_pk_bf16(float lo, float hi) { unsigned r; asm volatile("v_cvt_pk_bf16_f32 %0, %1, %2" : "=v"(r) : "v"(lo), "v"(hi)); return r; }

struct EpiStoreBf16 {
    static constexpr bool PERM = true, AFTER_DRAIN = false;
    bf16_t* O; int ldc;
    __device__ __forceinline__ void operator()(const f32x4 (&acc)[2][2][4][2], const Unit& u, int wr, int wc, int fr, int fq) const {
        const int row0 = u.pm * BM + wr * 64 + fr, col0 = u.pn * BM + wc * 32 + 8 * fq;
#pragma unroll
        for (int ai = 0; ai < 2; ++ai)
#pragma unroll
            for (int m = 0; m < 4; ++m) { bf16_t* rowp = O + (size_t)(row0 + ai * HALF + m * 16) * ldc + col0;
#pragma unroll
                for (int bj = 0; bj < 2; ++bj) { const f32x4 v0 = acc[ai][bj][m][0], v1 = acc[ai][bj][m][1];
                    u32x4 w; w.x = cvt_pk_bf16(v0[0], v0[1]); w.y = cvt_pk_bf16(v0[2], v0[3]); w.z = cvt_pk_bf16(v1[0], v1[1]); w.w = cvt_pk_bf16(v1[2], v1[3]);
                    *(u32x4*)(rowp + bj * HALF) = w; } }
    }
};
struct EpiGate {
    static constexpr bool PERM = false, AFTER_DRAIN = false;
    const bf16_t* XC; unsigned* LAU; const float* b_a; const float* b_x; const float* sp2;
    __device__ __forceinline__ void operator()(const f32x4 (&acc)[2][2][4][2], const Unit& u, int wr, int wc, int fr_, int fq_) const {
        int t_ = threadIdx.x; asm volatile("" : "+v"(t_));
        const int fr = t_ & 15, fq = (t_ >> 4) & 3;
        const int row0 = u.pm * BM + wr * 64 + fr;
#pragma unroll
        for (int n = 0; n < 2; ++n) {
            const int ch0 = u.pn * 128 + wc * 32 + n * 16 + fq * 4;
            const f32x4 ba = *(const f32x4*)(b_a + ch0), bx = *(const f32x4*)(b_x + ch0), sp = *(const f32x4*)(sp2 + ch0);
#pragma unroll
            for (int ai = 0; ai < 2; ++ai)
#pragma unroll
                for (int m = 0; m < 4; ++m) {
                    const size_t off = (size_t)(row0 + ai * HALF + m * 16) * 1536 + ch0;
                    const u32x2 xw = *(const u32x2*)(XC + off);
                    float xc[4] = {__uint_as_float(xw.x << 16), __uint_as_float(xw.x & 0xffff0000u), __uint_as_float(xw.y << 16), __uint_as_float(xw.y & 0xffff0000u)};
                    const f32x4 ar = acc[ai][0][m][n], ag = acc[ai][1][m][n];
                    u32x4 o;
#pragma unroll
                    for (int j = 0; j < 4; ++j) {
                        const float r = __builtin_amdgcn_rcpf(1.0f + __builtin_amdgcn_exp2f(-(ar[j] + ba[j]) * 1.4426950408889634f));
                        const float ig = __builtin_amdgcn_rcpf(1.0f + __builtin_amdgcn_exp2f(-(ag[j] + bx[j]) * 1.4426950408889634f));
                        const float l2a = -r * sp[j];
                        const float om = 1.0f - __builtin_amdgcn_exp2f(2.0f * l2a);
                        const float uu = __builtin_amdgcn_sqrtf(fmaxf(om, 0.0f)) * (ig * xc[j]);
                        o[j] = cvt_pk_bf16(l2a, uu);
                    }
                    *(u32x4*)(LAU + off) = o;
                    __builtin_amdgcn_sched_barrier(0);
                }
        }
    }
};
struct EpiY {
    static constexpr bool PERM = false, AFTER_DRAIN = false;
    float* Y; float* SSQ;
    __device__ __forceinline__ void operator()(const f32x4 (&acc)[2][2][4][2], const Unit& u, int wr, int wc, int fr, int fq) const {
        const int row0 = u.pm * BM + wr * 64 + fr, col0 = u.pn * BM + wc * 32 + 4 * fq;
#pragma unroll
        for (int ai = 0; ai < 2; ++ai)
#pragma unroll
            for (int m = 0; m < 4; ++m) { const int row = row0 + ai * HALF + m * 16; float* rowp = Y + (size_t)row * 1024 + col0; float s = 0.f;
#pragma unroll
                for (int bj = 0; bj < 2; ++bj)
#pragma unroll
                    for (int n = 0; n < 2; ++n) { const f32x4 v = acc[ai][bj][m][n]; s += (v[0] * v[0] + v[1] * v[1]) + (v[2] * v[2] + v[3] * v[3]); *(f32x4*)(rowp + bj * HALF + n * 16) = v; }
                s += __shfl_xor(s, 16); s += __shfl_xor(s, 32);
                if (fq == 0) SSQ[(size_t)row * 16 + u.pn * 4 + wc] = s; }
    }
};
struct EpiFox {
    static constexpr bool PERM = true, AFTER_DRAIN = false;
    bf16_t *Q, *K, *V, *SG; float* out; float* LFW; const float* b_f;
    __device__ __forceinline__ void operator()(const f32x4 (&acc)[2][2][4][2], const Unit& u, int wr, int wc, int fr, int fq) const {
        const int row0 = u.pm * BM + wr * 64 + fr; const int kind = u.pn >> 2;
        const int colb = (u.pn & 3) * BM + wc * 32 + 8 * fq;
        if (kind == 4) {
            if (wc == 0 && fq < 2) {
#pragma unroll
                for (int ai = 0; ai < 2; ++ai)
#pragma unroll
                    for (int m = 0; m < 4; ++m) { const int row = row0 + ai * HALF + m * 16;
                        float* op = (row < 32768) ? out + 101199872ull + (size_t)row * 16 : out + 102871040ull + (size_t)(row - 32768) * 16;
#pragma unroll
                        for (int n = 0; n < 2; ++n) { f32x4 lf;
#pragma unroll
                            for (int j = 0; j < 4; ++j) { const float z = acc[ai][0][m][n][j] + b_f[8 * fq + 4 * n + j]; lf[j] = fminf(z, 0.f) - log1pf(__expf(-fabsf(z))); }
                            *(f32x4*)(op + 8 * fq + 4 * n) = lf; *(f32x4*)(LFW + (size_t)row * 16 + 8 * fq + 4 * n) = lf; } }
            }
            return;
        }
        bf16_t* B = kind == 0 ? Q : kind == 1 ? K : kind == 2 ? V : SG;
#pragma unroll
        for (int ai = 0; ai < 2; ++ai)
#pragma unroll
            for (int m = 0; m < 4; ++m) { const int row = row0 + ai * HALF + m * 16;
#pragma unroll
                for (int bj = 0; bj < 2; ++bj) { f32x4 v0 = acc[ai][bj][m][0], v1 = acc[ai][bj][m][1]; const int col = colb + bj * HALF;
                    if (kind == 1 || kind == 2) {
                        float* op = (row < 32768) ? out + (kind == 1 ? 34091008ull : 67645440ull) + (size_t)row * 1024 : out + (kind == 1 ? 101822464ull : 102346752ull) + (size_t)(row - 32768) * 1024;
                        *(f32x4*)(op + col) = v0; *(f32x4*)(op + col + 4) = v1;
                    } else if (kind == 0) { v0 = v0 * (0.125f * 1.4426950408889634f); v1 = v1 * (0.125f * 1.4426950408889634f); }
                    else {
#pragma unroll
                        for (int j = 0; j < 4; ++j) { v0[j] = v0[j] * __builtin_amdgcn_rcpf(1.0f + __builtin_amdgcn_exp2f(-v0[j] * 1.4426950408889634f)); v1[j] = v1[j] * __builtin_amdgcn_rcpf(1.0f + __builtin_amdgcn_exp2f(-v1[j] * 1.4426950408889634f)); }
                    }
                    u32x4 w; w.x = cvt_pk_bf16(v0[0], v0[1]); w.y = cvt_pk_bf16(v0[2], v0[3]); w.z = cvt_pk_bf16(v1[0], v1[1]); w.w = cvt_pk_bf16(v1[2], v1[3]);
                    *(u32x4*)(B + (size_t)row * 1024 + col) = w; } }
    }
};
template <class Epi, class Sched, bool ALIGN_EPI = false, bool SP2 = false>
__device__ __forceinline__ void gemm_phase(PG8_LAS unsigned char* lds, const Gemm g, const Sched& S, const Epi& E) {
    int tid_ = threadIdx.x; asm volatile("" : "+v"(tid_)); const int tid = tid_, wid = __builtin_amdgcn_readfirstlane(tid >> 6), lane = tid & 63, wr = wid >> 2, wc = wid & 3, fr = lane & 15, fq = lane >> 4;
    const int K = g.K, nt = K / BK;
    unsigned voffA[2], voffB[2];
#pragma unroll
    for (int i = 0; i < 2; ++i) { int R, C; stage_rc(tid * 16 + i * 8192, R, C); const int Rb = Epi::PERM ? ((R & ~31) + perm32(R & 31)) : R;
        voffA[i] = (unsigned)(R * g.lda + C) * 2u; voffB[i] = (unsigned)(Rb * g.ldb + C) * 2u; }
    const size_t kstep = (size_t)(BK * 2);
    const size_t hstepA = (size_t)HALF * g.lda * 2, hstepB = (size_t)HALF * g.ldb * 2;
    const size_t tstepA = 2 * hstepA, tstepB = 2 * hstepB;
    const unsigned ldsw = (unsigned)wid * 1024u;
    const int aoff = lds_byte(wr * 64 + fr, fq * 8), boff = lds_byte(wc * 32 + fr, fq * 8);
#define PG8_SA(b, h) (((b) * 2 + (h)) * HTB)
#define PG8_SB(b, h) ((4 + (b) * 2 + (h)) * HTB)
#define PG8_STAGE(bufoff, gbase, voff) do { _Pragma("unroll") for (int _i = 0; _i < 2; ++_i) \
        __builtin_amdgcn_global_load_lds((const unsigned*)((const char*)(gbase) + (voff)[_i]), (PG8_LAS unsigned*)(lds + (bufoff) + ldsw + _i * 8192), 16, 0, 0); } while (0)
#define PG8_LDA(dst, b, h) do { _Pragma("unroll") for (int m = 0; m < 4; ++m) _Pragma("unroll") for (int k = 0; k < 2; ++k) dst[m][k] = *(const PG8_LAS bf16x8*)(lds + PG8_SA(b, h) + aoff + m * 2048 + k * 1024); } while (0)
#define PG8_LDB(dst, b, h) do { _Pragma("unroll") for (int n = 0; n < 2; ++n) _Pragma("unroll") for (int k = 0; k < 2; ++k) dst[n][k] = *(const PG8_LAS bf16x8*)(lds + PG8_SB(b, h) + boff + n * 2048 + k * 1024); } while (0)
#define PG8_MMA(ai, bj, At, Bt) do { __builtin_amdgcn_s_setprio(1); _Pragma("unroll") for (int m = 0; m < 4; ++m) _Pragma("unroll") for (int n = 0; n < 2; ++n) _Pragma("unroll") for (int k = 0; k < 2; ++k) \
        acc[ai][bj][m][n] = __builtin_amdgcn_mfma_f32_16x16x32_bf16(Bt[n][k], At[m][k], acc[ai][bj][m][n], 0, 0, 0); __builtin_amdgcn_s_setprio(0); } while (0)
#define PG8_WAIT_V(n) asm volatile("s_waitcnt vmcnt(" #n ")" ::: "memory")
#define PG8_WAIT_L(n) asm volatile("s_waitcnt lgkmcnt(" #n ")" ::: "memory")
#define PG8_BAR __builtin_amdgcn_s_barrier()
#define PG8_SCHED __builtin_amdgcn_sched_barrier(0)
    Unit cur, nxt; int ui = 0;
    if (!S.next(0, cur)) return;
    f32x4 acc[2][2][4][2];
#pragma unroll
    for (int a = 0; a < 2; ++a)
#pragma unroll
        for (int b = 0; b < 2; ++b)
#pragma unroll
            for (int m = 0; m < 4; ++m)
#pragma unroll
                for (int n = 0; n < 2; ++n) acc[a][b][m][n] = (f32x4){0.f, 0.f, 0.f, 0.f};
    bf16x8 At[4][2], B0[2][2], B1[2][2];
    const char* cA = (const char*)g.A + (size_t)cur.pm * tstepA + (size_t)cur.pn * g.a_pn_off; const char* cB = (const char*)g.Bt + (size_t)cur.pn * tstepB;
    S.a_ready(cur);
    if constexpr (SP2) {
        PG8_STAGE(PG8_SB(0, 0), cB, voffB); PG8_STAGE(PG8_SB(0, 1), cB + hstepB, voffB); PG8_STAGE(PG8_SA(0, 0), cA, voffA); PG8_STAGE(PG8_SA(0, 1), cA + hstepA, voffA);
        if (wr == 1) PG8_BAR;
        PG8_WAIT_V(2); PG8_BAR;
        PG8_STAGE(PG8_SB(1, 0), cB + kstep, voffB); PG8_STAGE(PG8_SA(1, 0), cA + kstep, voffA); PG8_STAGE(PG8_SB(1, 1), cB + hstepB + kstep, voffB);
        PG8_WAIT_V(6); PG8_BAR;
    } else {
        PG8_STAGE(PG8_SB(0, 0), cB, voffB); PG8_STAGE(PG8_SA(0, 0), cA, voffA); PG8_STAGE(PG8_SB(0, 1), cB + hstepB, voffB); PG8_STAGE(PG8_SA(0, 1), cA + hstepA, voffA);
        if (wr == 1) PG8_BAR;
        PG8_WAIT_V(4); PG8_BAR;
        PG8_STAGE(PG8_SB(1, 0), cB + kstep, voffB); PG8_STAGE(PG8_SA(1, 0), cA + kstep, voffA); PG8_STAGE(PG8_SB(1, 1), cB + hstepB + kstep, voffB);
        PG8_WAIT_V(6); PG8_BAR;
    }
    for (;;) {
        const bool has_next = S.next(ui + 1, nxt);
        const char* nA = has_next ? (const char*)g.A + (size_t)nxt.pm * tstepA + (size_t)nxt.pn * g.a_pn_off : cA; const char* nB = has_next ? (const char*)g.Bt + (size_t)nxt.pn * tstepB : cB;
        for (int t = 0; t < nt; t += 2) {
            const bool last = (t == nt - 2);
            const char* a1 = cA + (size_t)(t + 1) * kstep;
            const char* a2 = last ? nA : cA + (size_t)(t + 2) * kstep; const char* b2 = last ? nB : cB + (size_t)(t + 2) * kstep;
            const char* a3 = a2 + kstep; const char* b3 = b2 + kstep;
            if (last && has_next) S.a_ready(nxt);
            if constexpr (SP2) {
            PG8_LDB(B0, 0, 0); PG8_LDB(B1, 0, 1); PG8_SCHED; PG8_LDA(At, 0, 0); PG8_STAGE(PG8_SA(1, 1), a1 + hstepA, voffA);
            PG8_WAIT_V(8); PG8_WAIT_L(0); PG8_BAR; PG8_MMA(0, 0, At, B0); PG8_MMA(0, 1, At, B1); PG8_BAR; PG8_SCHED;
            PG8_LDA(At, 0, 1); PG8_STAGE(PG8_SB(0, 0), b2, voffB); PG8_STAGE(PG8_SB(0, 1), b2 + hstepB, voffB); PG8_STAGE(PG8_SA(0, 0), a2, voffA);
            PG8_WAIT_V(8); PG8_WAIT_L(0); PG8_BAR; PG8_MMA(1, 0, At, B0); PG8_MMA(1, 1, At, B1); PG8_BAR; PG8_SCHED;
            PG8_LDB(B0, 1, 0); PG8_LDB(B1, 1, 1); PG8_SCHED; PG8_LDA(At, 1, 0); PG8_STAGE(PG8_SA(0, 1), a2 + hstepA, voffA);
            PG8_WAIT_V(8); PG8_WAIT_L(0); PG8_BAR; PG8_MMA(0, 0, At, B0); PG8_MMA(0, 1, At, B1); PG8_BAR; PG8_SCHED;
            PG8_LDA(At, 1, 1); PG8_STAGE(PG8_SB(1, 0), b3, voffB); PG8_STAGE(PG8_SB(1, 1), b3 + hstepB, voffB); PG8_STAGE(PG8_SA(1, 0), a3, voffA);
            PG8_WAIT_V(8); PG8_WAIT_L(0); PG8_BAR; PG8_MMA(1, 0, At, B0); PG8_MMA(1, 1, At, B1); PG8_BAR; PG8_SCHED;
            } else {
            PG8_LDB(B0, 0, 0); PG8_SCHED; PG8_LDA(At, 0, 0); PG8_STAGE(PG8_SA(1, 1), a1 + hstepA, voffA);
            PG8_WAIT_L(8); PG8_BAR; PG8_WAIT_L(0); PG8_MMA(0, 0, At, B0); PG8_BAR; PG8_SCHED;
            PG8_LDB(B1, 0, 1); PG8_STAGE(PG8_SB(0, 0), b2, voffB);
            PG8_BAR; PG8_WAIT_L(0); PG8_MMA(0, 1, At, B1); PG8_BAR;
            PG8_LDA(At, 0, 1); PG8_STAGE(PG8_SA(0, 0), a2, voffA);
            PG8_BAR; PG8_WAIT_L(0); PG8_MMA(1, 0, At, B0); PG8_BAR; PG8_SCHED;
            PG8_STAGE(PG8_SB(0, 1), b2 + hstepB, voffB);
            PG8_WAIT_V(6); PG8_BAR; PG8_MMA(1, 1, At, B1); PG8_BAR;
            PG8_LDB(B0, 1, 0); PG8_SCHED; PG8_LDA(At, 1, 0); PG8_STAGE(PG8_SA(0, 1), a2 + hstepA, voffA);
            PG8_WAIT_L(8); PG8_BAR; PG8_WAIT_L(0); PG8_MMA(0, 0, At, B0); PG8_BAR; PG8_SCHED;
            PG8_LDB(B1, 1, 1); PG8_STAGE(PG8_SB(1, 0), b3, voffB);
            PG8_BAR; PG8_WAIT_L(0); PG8_MMA(0, 1, At, B1); PG8_BAR;
            PG8_LDA(At, 1, 1); PG8_STAGE(PG8_SA(1, 0), a3, voffA);
            PG8_BAR; PG8_WAIT_L(0); PG8_MMA(1, 0, At, B0); PG8_BAR; PG8_SCHED;
            PG8_STAGE(PG8_SB(1, 1), b3 + hstepB, voffB);
            PG8_WAIT_V(6); PG8_BAR; PG8_MMA(1, 1, At, B1); PG8_BAR;
            }
        }
        if constexpr (ALIGN_EPI) { if (wr == 0) PG8_BAR; }
        if constexpr (!Epi::AFTER_DRAIN) { E(acc, cur, wr, wc, fr, fq); S.done(cur); }
        if (!has_next) break;
#pragma unroll
        for (int a = 0; a < 2; ++a)
#pragma unroll
            for (int b = 0; b < 2; ++b)
#pragma unroll
                for (int m = 0; m < 4; ++m)
#pragma unroll
                    for (int n = 0; n < 2; ++n) acc[a][b][m][n] = (f32x4){0.f, 0.f, 0.f, 0.f};
        cur = nxt; cA = nA; cB = nB; ++ui;
        if constexpr (ALIGN_EPI) { if (wr == 1) PG8_BAR; }
    }
    PG8_WAIT_V(0);
    if constexpr (!ALIGN_EPI) { if (wr == 0) PG8_BAR; }
    PG8_BAR;
    if constexpr (Epi::AFTER_DRAIN) { E.fused(acc, cur, wr, wc, fr, fq, lds, wid, lane); S.done(cur); }
#undef PG8_SA
#undef PG8_SB
#undef PG8_STAGE
#undef PG8_LDA
#undef PG8_LDB
#undef PG8_MMA
#undef PG8_WAIT_V
#undef PG8_WAIT_L
#undef PG8_BAR
#undef PG8_SCHED
}
}

namespace attn_body {
using bf16=__hip_bfloat16;
using bf16x8=__attribute__((ext_vector_type(8)))short;
using s16x4=__attribute__((ext_vector_type(4)))short;
using f32x16=__attribute__((ext_vector_type(16)))float;
using u32x4=__attribute__((ext_vector_type(4)))unsigned;
constexpr int BATCH=2,NHEAD=16,SEQ=16384,D=64,DM=NHEAD*D;
constexpr int NW=8,QBLK=32,QB=QBLK*NW,KVBLK=64,NQB=SEQ/QB;
constexpr int ATTN_PITCH=DM, ATTN_UNIT_ROWS=QB;
__device__ __forceinline__ int crow(int r,int hi){return (r&3)+8*(r>>2)+4*hi;}
#define SBAR() __builtin_amdgcn_sched_barrier(0)
__device__ __forceinline__ void cmask(f32x16&p0,f32x16&p1,int jb,int qrel,int hi){
  const float NEG=-INFINITY; int kb=64*jb+4*hi;
  #pragma unroll
  for(int r=0;r<16;++r){int kv=kb+(r&3)+8*(r>>2); if(kv>qrel)p0[r]=NEG; if(kv+32>qrel)p1[r]=NEG;}
}

constexpr int NSLOT=3, SLOTB=8192;
constexpr int LDS_K=0, LDS_V=NSLOT*SLOTB, LDS_WS=2*NSLOT*SLOTB, LDS_OST=LDS_WS+NW*64*4, LDS_BYTES=LDS_OST+NW*4096;
constexpr float C2=0.125f*1.4426950408889634f;
__device__ __forceinline__ void glds16(const void*gsrc,unsigned lds_dst){unsigned keep;
  asm volatile("s_mov_b32 %0, m0\n\ts_mov_b32 m0, %2\n\ts_nop 0\n\tglobal_load_lds_dwordx4 %1, off\n\ts_mov_b32 m0, %0":"=&s"(keep):"v"(gsrc),"s"(lds_dst):"memory");}
__device__ __forceinline__ float max3f(float a,float b,float c){float r;asm("v_max3_f32 %0, %1, %2, %3":"=v"(r):"v"(a),"v"(b),"v"(c));return r;}
__device__ __forceinline__ float max2f(float a,float b){float r;asm("v_max_f32_e32 %0, %1, %2":"=v"(r):"v"(a),"v"(b));return r;}
__device__ __forceinline__ float fadd_s(float a,float b){float r;asm("v_add_f32_e32 %0, %1, %2":"=v"(r):"v"(a),"v"(b));return r;}
__device__ __forceinline__ float fsub_s(float a,float b){float r;asm("v_sub_f32_e32 %0, %1, %2":"=v"(r):"v"(a),"v"(b));return r;}
typedef float f32x2_t __attribute__((ext_vector_type(2))); typedef __bf16 bf16x2_t __attribute__((ext_vector_type(2)));
__device__ __forceinline__ unsigned cvtpk_s(float lo,float hi){f32x2_t v={lo,hi};bf16x2_t b=__builtin_convertvector(v,bf16x2_t);return __builtin_bit_cast(unsigned,b);}
#define WAIT_BAR(N) asm volatile("s_waitcnt vmcnt(" #N ") lgkmcnt(0)\n\ts_barrier":::"memory")

__device__ __forceinline__ void qkt(f32x16&p0,f32x16&p1,const char*Kslot,const bf16x8*qr,const f32x16 c0in,const f32x16 c1in,int r32,int hi){
  const char*kb=Kslot+hi*1024+r32*16;
  #pragma unroll
  for(int d0=0;d0<4;++d0){
    const bf16x8 b0=*reinterpret_cast<const bf16x8*>(kb+d0*2048);
    const bf16x8 b1=*reinterpret_cast<const bf16x8*>(kb+d0*2048+512);
    if(d0==0){p0=__builtin_amdgcn_mfma_f32_32x32x16_bf16(b0,qr[0],c0in,0,0,0);p1=__builtin_amdgcn_mfma_f32_32x32x16_bf16(b1,qr[0],c1in,0,0,0);}
    else{p0=__builtin_amdgcn_mfma_f32_32x32x16_bf16(b0,qr[d0],p0,0,0,0);p1=__builtin_amdgcn_mfma_f32_32x32x16_bf16(b1,qr[d0],p1,0,0,0);}}
}
typedef __attribute__((address_space(3))) const char* lds_cptr;
typedef short v4i16_t __attribute__((ext_vector_type(4)));
__device__ __forceinline__ void kload8(bf16x8*kf,lds_cptr kp){
  kf[0]=*(const __attribute__((address_space(3))) bf16x8*)(kp);      kf[1]=*(const __attribute__((address_space(3))) bf16x8*)(kp+512);
  kf[2]=*(const __attribute__((address_space(3))) bf16x8*)(kp+2048); kf[3]=*(const __attribute__((address_space(3))) bf16x8*)(kp+2560);
  kf[4]=*(const __attribute__((address_space(3))) bf16x8*)(kp+4096); kf[5]=*(const __attribute__((address_space(3))) bf16x8*)(kp+4608);
  kf[6]=*(const __attribute__((address_space(3))) bf16x8*)(kp+6144); kf[7]=*(const __attribute__((address_space(3))) bf16x8*)(kp+6656);
}
__device__ __forceinline__ void kload2(bf16x8*kf,lds_cptr kp,int j){ kf[2*j]=*(const __attribute__((address_space(3))) bf16x8*)(kp+j*2048); kf[2*j+1]=*(const __attribute__((address_space(3))) bf16x8*)(kp+j*2048+512); }
__device__ __forceinline__ s16x4 vtr(lds_cptr p){ return __builtin_bit_cast(s16x4,__builtin_amdgcn_ds_read_tr16_b64_v4i16((__attribute__((address_space(3))) v4i16_t*)p)); }
__device__ __forceinline__ float rowmax(const f32x16&p0,const f32x16&p1){
  float a=max3f(p0[0],p0[1],p1[0]),b=max3f(p0[2],p0[3],p1[1]);a=max3f(a,p1[2],p1[3]);
  #pragma unroll
  for(int r=4;r<16;r+=4){a=max3f(a,p0[r],p0[r+1]);b=max3f(b,p0[r+2],p0[r+3]);a=max3f(a,p1[r],p1[r+1]);b=max3f(b,p1[r+2],p1[r+3]);}
  const float m=max2f(a,b);
  auto rr=__builtin_amdgcn_permlane32_swap(__float_as_uint(m),__float_as_uint(m),false,false);
  return max2f(__uint_as_float(rr[0]),__uint_as_float(rr[1]));
}
__device__ __forceinline__ void pv(f32x16*o,int vb,bf16x8 pa0,bf16x8 pa1,bf16x8 pa2,bf16x8 pa3){
  #pragma unroll
  for(int d0=0;d0<2;++d0){s16x4 lo[4],hi[4];
    #pragma unroll
    for(int ks=0;ks<4;++ks){
      asm volatile("ds_read_b64_tr_b16 %0,%1 offset:%c2":"=&v"(lo[ks]):"v"(vb),"i"(d0*4096+ks*1024):"memory");
      asm volatile("ds_read_b64_tr_b16 %0,%1 offset:%c2":"=&v"(hi[ks]):"v"(vb),"i"(d0*4096+ks*1024+512):"memory");}
    asm volatile("s_waitcnt lgkmcnt(0)":::"memory");SBAR();
    #define PK(k) (bf16x8){lo[k][0],lo[k][1],lo[k][2],lo[k][3],hi[k][0],hi[k][1],hi[k][2],hi[k][3]}
    o[d0]=__builtin_amdgcn_mfma_f32_32x32x16_bf16(pa0,PK(0),o[d0],0,0,0);
    o[d0]=__builtin_amdgcn_mfma_f32_32x32x16_bf16(pa1,PK(1),o[d0],0,0,0);
    o[d0]=__builtin_amdgcn_mfma_f32_32x32x16_bf16(pa2,PK(2),o[d0],0,0,0);
    o[d0]=__builtin_amdgcn_mfma_f32_32x32x16_bf16(pa3,PK(3),o[d0],0,0,0);
    #undef PK
  }
}

typedef const __attribute__((address_space(3))) float* lds_fptr;
__device__ __forceinline__ bf16x8 mkbias(float b){ const unsigned ub=__float_as_uint(b),h=ub&0xffff0000u; const float r1=b-__uint_as_float(h); const unsigned m=__float_as_uint(r1)&0xffff0000u;
  const float r2=r1-__uint_as_float(m); u32x4 w; w.x=(h>>16)|m; w.y=__float_as_uint(r2)>>16; w.z=0u; w.w=0u; return __builtin_bit_cast(bf16x8,w); }
#ifndef ATTN_STORE16
#define ATTN_STORE16(p,v) (*(u32x4*)(p)=(v))
#endif
template<int THRL> __device__ __forceinline__ void attn_unit(int b,int h,int qb,const bf16*Q,const bf16*__restrict__ K,const bf16*__restrict__ V,bf16*O,const bf16*__restrict__ SGp,lds_fptr bet,char*shm){
  int tid_=threadIdx.x; asm volatile("":"+v"(tid_)); const int tid=tid_,lane=tid&63,r32=lane&31,hi=lane>>5; const int wid=__builtin_amdgcn_readfirstlane(tid>>6);
  const long rowbase=(long)b*SEQ; const int q0=qb*QB;
  const bf16*Qw=Q+(rowbase+q0+wid*QBLK)*DM+h*D;
  const bf16*Kh=K+rowbase*DM+h*D,*Vh=V+rowbase*DM+h*D;
  const unsigned lds0=(unsigned)(uintptr_t)shm;
  float*wsf=(float*)(shm+LDS_WS)+wid*64;
  const bf16*ksrc=Kh+(long)lane*DM+wid*8;
  const bf16*vsrc=Vh+(long)(16*(wid&3)+(lane>>2))*DM+(wid>>2)*32+(lane&3)*8;
  const unsigned kdst=lds0+LDS_K+wid*1024, vdst=lds0+LDS_V+wid*1024;
  #define DMA_K(t,slot) glds16(ksrc+(long)(t)*KVBLK*DM,(unsigned)__builtin_amdgcn_readfirstlane(kdst+(slot)))
  #define DMA_V(t,slot) glds16(vsrc+(long)(t)*KVBLK*DM,(unsigned)__builtin_amdgcn_readfirstlane(vdst+(slot)))
  const int vb0=(int)(lds0+LDS_V)+((lane>>4)&1)*32+(lane&3)*8+(4*hi+((lane&15)>>2))*64;
  const char*Kbase=shm+LDS_K; bf16x8 kf[8];
  const lds_cptr shm3=(lds_cptr)shm; const lds_cptr kp0=shm3+LDS_K+hi*1024+r32*16; const lds_cptr vp0=shm3+LDS_V+((lane>>4)&1)*32+(lane&3)*8+(4*hi+((lane&15)>>2))*64;
  const int NT=(q0+QB)/KVBLK;
  DMA_K(0,0);DMA_V(0,0);DMA_K(1,SLOTB);
  bf16x8 qr[4];
  #pragma unroll
  for(int d0=0;d0<4;++d0)qr[d0]=*reinterpret_cast<const bf16x8*>(&Qw[(long)r32*DM+d0*16+hi*8]);
  float mhat=0.f,l_reg=0.f;f32x16 o[2];o[0]=f32x16{};o[1]=f32x16{};f32x16 negm=f32x16{};asm volatile("":"+v"(negm));
  const int qrel=wid*QBLK+r32;
  const float bref=bet[q0];
  bf16x8 onesv; { u32x4 w_; w_.x=hi?0u:0x3F803F80u; w_.y=hi?0u:0x00003F80u; w_.z=0u; w_.w=0u; onesv=__builtin_bit_cast(bf16x8,w_); }
  #define BIASOP(t,AB0,AB1) do{ const float b0_=bet[(t)*64+r32]-bref, b1_=bet[(t)*64+32+r32]-bref; AB0=mkbias(b0_); AB1=mkbias(b1_); }while(0)
  #define CMASK(P0,P1,t) do{int jb_=(t)-(NT-4); if(jb_>=0)cmask(P0,P1,jb_,qrel,hi);}while(0)
  bool resc=false;
  #define START(P0,P1) do{ const float rm=rowmax(P0,P1); resc=false; \
    { const float dl=rm; mhat=fadd_s(mhat,dl); \
      _Pragma("unroll") for(int r=0;r<16;++r){P0[r]=fsub_s(P0[r],dl);P1[r]=fsub_s(P1[r],dl);} \
      _Pragma("unroll") for(int r=0;r<16;++r)negm[r]=-mhat; asm volatile("":"+v"(negm)); } \
    _Pragma("unroll") for(int r=0;r<16;++r)P0[r]=__builtin_amdgcn_exp2f(P0[r]); }while(0)
  #define RESC() do{ if(resc){ asm volatile("s_waitcnt lgkmcnt(0)":::"memory"); \
      _Pragma("unroll") for(int d_=0;d_<2;++d_) _Pragma("unroll") for(int r=0;r<16;++r)o[d_][r]*=wsf[crow(r,hi)]; } }while(0)
  f32x16 pA0,pA1,pB0,pB1;
  int sl_prev=0,sl_cur=0,sl_next=SLOTB;
  #define ROT() do{sl_prev=sl_cur;sl_cur=sl_next;sl_next=(sl_next==(NSLOT-1)*SLOTB)?0:sl_next+SLOTB;}while(0)
  DMA_K(2,2*SLOTB);
  WAIT_BAR(3);
  { bf16x8 ab0_,ab1_; BIASOP(0,ab0_,ab1_); pA0=__builtin_amdgcn_mfma_f32_32x32x16_bf16(ab0_,onesv,negm,0,0,0); pA1=__builtin_amdgcn_mfma_f32_32x32x16_bf16(ab1_,onesv,negm,0,0,0); }
  qkt(pA0,pA1,Kbase,qr,pA0,pA1,r32,hi);asm volatile("s_nop 15\n\ts_nop 7":"+v"(pA0),"+v"(pA1));CMASK(pA0,pA1,0);
  START(pA0,pA1);
  _Pragma("unroll") for(int r=0;r<16;++r)pA1[r]=__builtin_amdgcn_exp2f(pA1[r]);
  WAIT_BAR(0);
  DMA_K(3,0);DMA_V(1,SLOTB);
  ROT();
  kload8(kf,kp0+sl_cur);
  WAIT_BAR(2);
  s16x4 vlo[8],vhi[8]; u32x4 pw0,pw1,pw2,pw3;
  #define PKW(P,B) cvtpk_s(P[B],P[B+1])
  #define PAF(k) __builtin_bit_cast(bf16x8,pw##k)
  #define VFR(i) (bf16x8){vlo[i][0],vlo[i][1],vlo[i][2],vlo[i][3],vhi[i][0],vhi[i][1],vhi[i][2],vhi[i][3]}
  #define PIN(x) asm volatile("":"+v"(x))
  #define MX3(a,b,c) __builtin_fmaxf(__builtin_fmaxf((a),(b)),(c))
  #define GAPA(MF,A0,A1,A2,A3,W0,W1,PW) do{ MF; sacc+=A0; sacc+=A1; sacc+=A2; sacc+=A3; PIN(sacc); W0; W1; PIN(PW); SBAR(); }while(0)
  #define EX(v) __builtin_amdgcn_exp2f(v)
  #define GAPB(MF,X,B) do{ MF; X[B]=EX(X[B]); X[B+1]=EX(X[B+1]); X[B+2]=EX(X[B+2]); X[B+3]=EX(X[B+3]); PIN(X); SBAR(); }while(0)
  #define VRD(i) do{ vlo[i]=vtr(vp_+(((i)>>2)*4096+((i)&3)*1024)); vhi[i]=vtr(vp_+(((i)>>2)*4096+((i)&3)*1024+512)); }while(0)
  #define KRD(G,j) do{ if(G){ kload2(kf,kp0+sl_next,j); SBAR(); } }while(0)
  #define STEP(C0,C1,P0,P1,t,GK,GV,GL) do{ SBAR(); \
    const lds_cptr vp_=vp0+sl_prev; \
    { bf16x8 ab0_,ab1_; BIASOP(t,ab0_,ab1_); C0=__builtin_amdgcn_mfma_f32_32x32x16_bf16(ab0_,onesv,negm,0,0,0); C1=__builtin_amdgcn_mfma_f32_32x32x16_bf16(ab1_,onesv,negm,0,0,0); } SBAR(); \
    VRD(0); SBAR(); float sacc=(P0[0]+P0[1]); \
    GAPA(C0=__builtin_amdgcn_mfma_f32_32x32x16_bf16(kf[0],qr[0],C0,0,0,0), P0[2],P0[3],P0[4],P0[5],     pw0[0]=PKW(P0,0), pw0[1]=PKW(P0,2), pw0); \
    VRD(4); SBAR(); GAPA(C1=__builtin_amdgcn_mfma_f32_32x32x16_bf16(kf[1],qr[0],C1,0,0,0), P0[6],P0[7],P0[8],P0[9],     pw0[2]=PKW(P0,4), pw0[3]=PKW(P0,6), pw0); \
    VRD(1); SBAR(); GAPA(C0=__builtin_amdgcn_mfma_f32_32x32x16_bf16(kf[2],qr[1],C0,0,0,0),   P0[10],P0[11],P0[12],P0[13], pw1[0]=PKW(P0,8), pw1[1]=PKW(P0,10), pw1); \
    VRD(5); SBAR(); GAPA(C1=__builtin_amdgcn_mfma_f32_32x32x16_bf16(kf[3],qr[1],C1,0,0,0),   P0[14],P0[15],P1[0],P1[1],   pw1[2]=PKW(P0,12),pw1[3]=PKW(P0,14), pw1); \
    VRD(2); SBAR(); GAPA(C0=__builtin_amdgcn_mfma_f32_32x32x16_bf16(kf[4],qr[2],C0,0,0,0),   P1[2],P1[3],P1[4],P1[5],     pw2[0]=PKW(P1,0), pw2[1]=PKW(P1,2), pw2); \
    VRD(6); SBAR(); GAPA(C1=__builtin_amdgcn_mfma_f32_32x32x16_bf16(kf[5],qr[2],C1,0,0,0),   P1[6],P1[7],P1[8],P1[9],     pw2[2]=PKW(P1,4), pw2[3]=PKW(P1,6), pw2); \
    VRD(3); SBAR(); GAPA(C0=__builtin_amdgcn_mfma_f32_32x32x16_bf16(kf[6],qr[3],C0,0,0,0),   P1[10],P1[11],P1[12],P1[13], pw3[0]=PKW(P1,8), pw3[1]=PKW(P1,10), pw3); \
    VRD(7); SBAR(); GAPA(C1=__builtin_amdgcn_mfma_f32_32x32x16_bf16(kf[7],qr[3],C1,0,0,0),   P1[14],P1[15],0.f,0.f,       pw3[2]=PKW(P1,12),pw3[3]=PKW(P1,14), pw3); \
    l_reg+=sacc; \
    if(GK){DMA_K((t)+3,sl_cur);} if(GV){DMA_V((t)+1,sl_next);} \
    CMASK(C0,C1,t); \
    { float a=MX3(C0[0],C0[1],C1[0]),b=MX3(C0[2],C0[3],C1[1]); a=MX3(a,C1[2],C1[3]); \
      _Pragma("unroll") for(int r=4;r<16;r+=4){a=MX3(a,C0[r],C0[r+1]);b=MX3(b,C0[r+2],C0[r+3]);a=MX3(a,C1[r],C1[r+1]);b=MX3(b,C1[r+2],C1[r+3]);} \
      float rm=__builtin_fmaxf(a,b); { auto rr=__builtin_amdgcn_permlane32_swap(__float_as_uint(rm),__float_as_uint(rm),false,false); rm=__builtin_fmaxf(__uint_as_float(rr[0]),__uint_as_float(rr[1])); } \
      resc=false; \
      if(__builtin_expect(__any(rm>(float)THRL),0)){ const float dl=__builtin_fmaxf(rm,0.f); mhat+=dl; \
        _Pragma("unroll") for(int r=0;r<16;++r){C0[r]-=dl;C1[r]-=dl;} \
        _Pragma("unroll") for(int r=0;r<16;++r)negm[r]=-mhat; asm volatile("":"+v"(negm)); \
        const float f=__builtin_amdgcn_exp2f(-dl); l_reg*=f; if(hi==0)wsf[r32]=f; resc=true; } } \
    SBAR(); \
    GAPB(o[0]=__builtin_amdgcn_mfma_f32_32x32x16_bf16(PAF(0),VFR(0),o[0],0,0,0), C0,0); \
    GAPB(o[1]=__builtin_amdgcn_mfma_f32_32x32x16_bf16(PAF(0),VFR(4),o[1],0,0,0), C0,4); \
    KRD(GL,0); GAPB(o[0]=__builtin_amdgcn_mfma_f32_32x32x16_bf16(PAF(1),VFR(1),o[0],0,0,0), C0,8); \
    KRD(GL,1); GAPB(o[1]=__builtin_amdgcn_mfma_f32_32x32x16_bf16(PAF(1),VFR(5),o[1],0,0,0), C0,12); \
    KRD(GL,2); GAPB(o[0]=__builtin_amdgcn_mfma_f32_32x32x16_bf16(PAF(2),VFR(2),o[0],0,0,0), C1,0); \
    KRD(GL,3); GAPB(o[1]=__builtin_amdgcn_mfma_f32_32x32x16_bf16(PAF(2),VFR(6),o[1],0,0,0), C1,4); \
    GAPB(o[0]=__builtin_amdgcn_mfma_f32_32x32x16_bf16(PAF(3),VFR(3),o[0],0,0,0), C1,8); \
    GAPB(o[1]=__builtin_amdgcn_mfma_f32_32x32x16_bf16(PAF(3),VFR(7),o[1],0,0,0), C1,12); \
    }while(0)
  int t=1;
  #undef CMASK
  #define CMASK(P0,P1,t) do{}while(0)
  for(;t+5<NT;t+=2){
    STEP(pB0,pB1,pA0,pA1,t,true,true,true);     WAIT_BAR(2); RESC(); ROT();
    STEP(pA0,pA1,pB0,pB1,t+1,true,true,true);   WAIT_BAR(2); RESC(); ROT();
  }
  #undef CMASK
  #define CMASK(P0,P1,t) do{int jb_=(t)-(NT-4); if(jb_>=0)cmask(P0,P1,jb_,qrel,hi);}while(0)
  #define ENDW(tt) do{ if((tt)+3<NT){WAIT_BAR(2);} else if((tt)+2<NT){WAIT_BAR(1);} else {WAIT_BAR(0);} }while(0)
  for(;t+1<NT;t+=2){
    STEP(pB0,pB1,pA0,pA1,t,(t+3<NT),(t+1<NT),(t+1<NT));       ENDW(t);   RESC(); ROT();
    STEP(pA0,pA1,pB0,pB1,t+1,(t+4<NT),(t+2<NT),(t+2<NT));     ENDW(t+1); RESC(); ROT();
  }
  STEP(pB0,pB1,pA0,pA1,NT-1,false,false,false); RESC();
  { float sacc=pB0[0]+pB0[1]; _Pragma("unroll") for(int r=2;r<16;++r)sacc+=pB0[r]; _Pragma("unroll") for(int r=0;r<16;++r)sacc+=pB1[r]; l_reg+=sacc;
    pw0=(u32x4){PKW(pB0,0),PKW(pB0,2),PKW(pB0,4),PKW(pB0,6)};pw1=(u32x4){PKW(pB0,8),PKW(pB0,10),PKW(pB0,12),PKW(pB0,14)};pw2=(u32x4){PKW(pB1,0),PKW(pB1,2),PKW(pB1,4),PKW(pB1,6)};pw3=(u32x4){PKW(pB1,8),PKW(pB1,10),PKW(pB1,12),PKW(pB1,14)};
    SBAR(); pv(o,vb0+sl_cur,PAF(0),PAF(1),PAF(2),PAF(3)); }
  #undef PKW
  #undef PAF
  #undef VFR
  #undef PIN
  #undef MX3
  #undef GAPA
  #undef GAPB
  #undef EX
  #undef VRD
  #undef KRD
  #undef STEP
  #undef ENDW
  {auto rr=__builtin_amdgcn_permlane32_swap(__float_as_uint(l_reg),__float_as_uint(l_reg),false,false);l_reg=__uint_as_float(rr[0])+__uint_as_float(rr[1]);}
  if(hi==0)wsf[32+r32]=l_reg;asm volatile("s_waitcnt lgkmcnt(0)":::"memory");
  float rli[16];
  #pragma unroll
  for(int r=0;r<16;++r)rli[r]=__builtin_amdgcn_rcpf(wsf[32+crow(r,hi)]);
  bf16*Ow=O+(rowbase+q0+wid*QBLK)*DM+h*D; const bf16*SGw=SGp+(rowbase+q0+wid*QBLK)*DM+h*D;
  { bf16*stg=(bf16*)(shm+LDS_OST)+wid*2048;
    #pragma unroll
    for(int r=0;r<16;++r){const int orow=crow(r,hi);
      #pragma unroll
      for(int d0=0;d0<2;++d0)stg[orow*64+d0*32+r32]=__float2bfloat16(o[d0][r]*rli[r]);}
    asm volatile("s_waitcnt lgkmcnt(0)":::"memory");
    #pragma unroll
    for(int i=0;i<4;++i){const int row=i*8+(lane>>3),ch=lane&7; const u32x4 v=*(const u32x4*)(stg+row*64+ch*8); const u32x4 sg=*(const u32x4*)(SGw+(long)row*DM+ch*8); u32x4 w_;
      #pragma unroll
      for(int e=0;e<4;++e){ w_[e]=cvtpk_s(__uint_as_float(v[e]<<16)*__uint_as_float(sg[e]<<16),__uint_as_float(v[e]&0xffff0000u)*__uint_as_float(sg[e]&0xffff0000u)); }
      ATTN_STORE16(Ow+(long)row*DM+ch*8,w_);} }
  asm volatile("s_waitcnt lgkmcnt(0)\n\ts_barrier":::"memory");
  #undef DMA_K
  #undef BIASOP
  #undef DMA_V
  #undef CMASK
  #undef START
  #undef RESC
  #undef ROT
}

#undef SBAR
#undef WAIT_BAR
}


struct Args {
    const float* in[25]; float* out; unsigned char* ws;
};

typedef const __attribute__((address_space(4))) Args* KA;
__device__ __forceinline__ KA fresh_args() { auto p = __builtin_amdgcn_kernarg_segment_ptr(); asm volatile("" : "+s"(p)); return (KA)p; }

__device__ __forceinline__ const float* xrow_ptr(KA a, int m) { return m < MP ? a->in[0] + (size_t)m * 1024 : a->in[1] + (size_t)(m - MP) * 1024; }
__device__ __forceinline__ int seq_of(int m) { return m < MP ? (m >> 14) : 2 + ((m - MP) >> 5); }

__device__ __forceinline__ void transpose_tile(const float* src, int src_ld, int n_valid, bf16r* dst, int dst_ld, int k0, int n0, float* tile, int tid) {
    const int i = tid >> 6, j = tid & 63;
    __syncthreads();
#pragma unroll
    for (int kk = i; kk < 64; kk += 8) tile[kk * 65 + j] = (n0 + j < n_valid) ? src[(size_t)(k0 + kk) * src_ld + n0 + j] : 0.f;
    __syncthreads();
    const int nn = tid >> 3, kc = (tid & 7) * 8;
    u32x4 w;
    w.x = cvtpk(tile[(kc + 0) * 65 + nn], tile[(kc + 1) * 65 + nn]); w.y = cvtpk(tile[(kc + 2) * 65 + nn], tile[(kc + 3) * 65 + nn]);
    w.z = cvtpk(tile[(kc + 4) * 65 + nn], tile[(kc + 5) * 65 + nn]); w.w = cvtpk(tile[(kc + 6) * 65 + nn], tile[(kc + 7) * 65 + nn]);
    *(u32x4*)(dst + (size_t)(n0 + nn) * dst_ld + k0 + kc) = w;
}

__device__ __forceinline__ void phase_prologue(KA a, float* ldsf, int tid, int bid, int G) {
    for (int item = bid; item < 192; item += G) {
        const int l = item / 96, rem = item % 96, jb = rem / 16, ks = rem % 16;
        __syncthreads();
        for (int i = tid; i < 18 * 64; i += 512) { const int s = i >> 6, k = i & 63; const float c = (s < 2) ? a->in[2][s * 1024 + ks * 64 + k] : a->in[3][(s - 2) * 1024 + ks * 64 + k]; ldsf[i] = c / (1.0f + __expf(-c)); }
        __syncthreads();
        const int j = jb * 512 + tid;
        float acc[18];
#pragma unroll
        for (int s = 0; s < 18; ++s) acc[s] = 0.f;
        const float* w = a->in[11] + (size_t)l * 1024 * 3072 + (size_t)(ks * 64) * 3072 + j;
#pragma unroll 4
        for (int k = 0; k < 64; ++k) { const float wv = w[(size_t)k * 3072];
#pragma unroll
            for (int s = 0; s < 18; ++s) acc[s] += ldsf[s * 64 + k] * wv; }
        float* modp = (float*)(a->ws + WS_MODP);
#pragma unroll
        for (int s = 0; s < 18; ++s) modp[((size_t)(ks * 2 + l) * 18 + s) * 3072 + j] = acc[s];
    }
    for (int i = bid * 512 + tid; i < 1536; i += G * 512) { const float lam = a->in[20][i]; ((float*)(a->ws + WS_SP2))[i] = 8.0f * log1pf(__expf(-lam)) * LOG2E; }
    for (int it = bid; it < 2592; it += G) {
        if (it < 768) { const int kt = it / 48, nt = it % 48; transpose_tile(a->in[13], 3072, 3072, (bf16r*)(a->ws + WS_W0IN), 1024, kt * 64, nt * 64, ldsf, tid); }
        else if (it < 1152) { const int q = it - 768, kt = q / 16, nt = q % 16; transpose_tile(a->in[21], 1024, 1024, (bf16r*)(a->ws + WS_W0OUT), 1536, kt * 64, nt * 64, ldsf, tid); }
        else if (it < 2240) { const int q = it - 1152, kt = q / 68, nt = q % 68; transpose_tile(a->in[22], 4112, 4112, (bf16r*)(a->ws + WS_W1IN), 1024, kt * 64, nt * 64, ldsf, tid); }
        else if (it < 2496) { const int q = it - 2240, kt = q / 16, nt = q % 16; transpose_tile(a->in[24], 1024, 1024, (bf16r*)(a->ws + WS_W1OUT), 1024, kt * 64, nt * 64, ldsf, tid); }
        else { const int q = it - 2496, n = q >> 3, which = (q >> 2) & 1, kt = (q >> 1) & 1, nt = q & 1;
            transpose_tile((which ? a->in[18] : a->in[16]) + (size_t)n * 16384, 128, 128, (bf16r*)(a->ws + WS_WG) + (size_t)n * 32768 + which * 16384, 128, kt * 64, nt * 64, ldsf, tid); }
    }
    __syncthreads();
}

__device__ __forceinline__ void phase_mod_reduce(KA a, int tid, int bid, int G) {
    const float* modp = (const float*)(a->ws + WS_MODP); float* mod = (float*)(a->ws + WS_MOD);
    for (int i = bid * 512 + tid; i < 2 * 18 * 3072; i += G * 512) {
        const int l = i / (18 * 3072), r = i % (18 * 3072), j = r % 3072;
        float s = a->in[12][l * 3072 + j];
#pragma unroll
        for (int ks = 0; ks < 16; ++ks) s += modp[(size_t)(ks * 2 + l) * 18 * 3072 + r];
        mod[i] = s;
    }
}

template <int MODE> __device__ __forceinline__ void phase_rows(KA a, int lane, int gw, int ngw) {
    const float* mod = (const float*)(a->ws + WS_MOD);
    for (int m = gw; m < MT; m += ngw) {
        const int sq = seq_of(m);
        f32x4 v[4];
        if (MODE == 0) {
            const f32x4* xr = (const f32x4*)xrow_ptr(a, m) + lane;
#pragma unroll
            for (int i = 0; i < 4; ++i) v[i] = xr[64 * i];
        } else {
            const int lprev = (MODE == 1) ? 0 : 1;
            const f32x4* yr = (const f32x4*)((const float*)(a->ws + WS_Y) + (size_t)m * 1024) + lane;
            const f32x4* xr = (MODE == 1) ? (const f32x4*)xrow_ptr(a, m) + lane : (const f32x4*)((const float*)(a->ws + WS_X1) + (size_t)m * 1024) + lane;
            const float* sq16 = (const float*)(a->ws + WS_SSQ) + (size_t)m * 16;
            float ss = 0.f;
#pragma unroll
            for (int i = 0; i < 16; ++i) ss += sq16[i];
            const float rstd = 1.0f / sqrtf(ss * (1.0f / 1024.0f) + EPS_);
            const f32x4* gp = (const f32x4*)(a->in[10] + lprev * 1024) + lane;
            const f32x4* gt = (const f32x4*)(mod + ((size_t)lprev * 18 + sq) * 3072 + 2048) + lane;
#pragma unroll
            for (int i = 0; i < 4; ++i) { const f32x4 y = yr[64 * i], x = xr[64 * i], g = gp[64 * i], t = gt[64 * i]; v[i] = x + t * (y * rstd * g); }
            if (MODE == 1) { f32x4* xo = (f32x4*)((float*)(a->ws + WS_X1) + (size_t)m * 1024) + lane;
#pragma unroll
                for (int i = 0; i < 4; ++i) xo[64 * i] = v[i]; }
            else { float* orow = (m < MP) ? a->out + O_YP + (size_t)m * 1024 : a->out + O_YS + (size_t)(m - MP) * 1024; f32x4* xo = (f32x4*)orow + lane;
#pragma unroll
                for (int i = 0; i < 4; ++i) xo[64 * i] = v[i]; }
        }
        if (MODE != 2) {
            const int l = (MODE == 0) ? 0 : 1;
            float s = 0.f;
#pragma unroll
            for (int i = 0; i < 4; ++i) s += (v[i].x * v[i].x + v[i].y * v[i].y) + (v[i].z * v[i].z + v[i].w * v[i].w);
            s = wave_sum(s);
            const float rstd = 1.0f / sqrtf(s * (1.0f / 1024.0f) + EPS_);
            const f32x4* gp = (const f32x4*)(a->in[9] + l * 1024) + lane;
            const f32x4* sh = (const f32x4*)(mod + ((size_t)l * 18 + sq) * 3072) + lane;
            const f32x4* sc = (const f32x4*)(mod + ((size_t)l * 18 + sq) * 3072 + 1024) + lane;
            u32x2* ho = (u32x2*)((bf16r*)(a->ws + WS_H) + (size_t)m * 1024) + lane;
#pragma unroll
            for (int i = 0; i < 4; ++i) { const f32x4 g = gp[64 * i], h0 = sh[64 * i], c0 = sc[64 * i]; const f32x4 h = v[i] * rstd * g * (1.0f + c0) + h0;
                u32x2 w; w.x = cvtpk(h.x, h.y); w.y = cvtpk(h.z, h.w); ho[64 * i] = w; }
        }
    }
}

__device__ __forceinline__ void phase_conv(KA a, int gtid, int ngt) {
    const bf16r* XBG = (const bf16r*)(a->ws + WS_XBG); bf16r* XC = (bf16r*)(a->ws + WS_XC);
    for (int idx = gtid; idx < 1040 * 192; idx += ngt) {
        const int chunk = idx / 192, cgp = idx % 192, ch0 = cgp * 8, m0 = chunk * 32;
        const bool prompt = m0 < MP; const int t0 = prompt ? (m0 & (TP - 1)) : 0;
        float w0[8], w1[8], w2[8], w3[8], cb[8], xm3[8], xm2[8], xm1[8];
#pragma unroll
        for (int i = 0; i < 8; ++i) { w0[i] = a->in[14][ch0 + i]; w1[i] = a->in[14][1536 + ch0 + i]; w2[i] = a->in[14][3072 + ch0 + i]; w3[i] = a->in[14][4608 + ch0 + i]; cb[i] = a->in[15][ch0 + i]; }
        if (t0 == 0) {
            if (prompt) {
#pragma unroll
                for (int i = 0; i < 8; ++i) { xm3[i] = 0.f; xm2[i] = 0.f; xm1[i] = 0.f; }
            } else { const float* st = a->in[5] + (size_t)(chunk - 1024) * 3 * 1536 + ch0;
#pragma unroll
                for (int i = 0; i < 8; ++i) { xm3[i] = st[i]; xm2[i] = st[1536 + i]; xm1[i] = st[3072 + i]; } }
        } else {
            const u32x4 p3 = *(const u32x4*)(XBG + (size_t)(m0 - 3) * 3072 + ch0), p2 = *(const u32x4*)(XBG + (size_t)(m0 - 2) * 3072 + ch0), p1 = *(const u32x4*)(XBG + (size_t)(m0 - 1) * 3072 + ch0);
#pragma unroll
            for (int e = 0; e < 4; ++e) { xm3[2 * e] = bflo(p3[e]); xm3[2 * e + 1] = bfhi(p3[e]); xm2[2 * e] = bflo(p2[e]); xm2[2 * e + 1] = bfhi(p2[e]); xm1[2 * e] = bflo(p1[e]); xm1[2 * e + 1] = bfhi(p1[e]); }
        }
#pragma unroll 8
        for (int r = 0; r < 32; ++r) {
            const u32x4 pc = *(const u32x4*)(XBG + (size_t)(m0 + r) * 3072 + ch0);
            float cur[8], o[8];
#pragma unroll
            for (int e = 0; e < 4; ++e) { cur[2 * e] = bflo(pc[e]); cur[2 * e + 1] = bfhi(pc[e]); }
#pragma unroll
            for (int i = 0; i < 8; ++i) { o[i] = cb[i] + xm3[i] * w0[i] + xm2[i] * w1[i] + xm1[i] * w2[i] + cur[i] * w3[i]; xm3[i] = xm2[i]; xm2[i] = xm1[i]; xm1[i] = cur[i]; }
            u32x4 w; w.x = cvtpk(o[0], o[1]); w.y = cvtpk(o[2], o[3]); w.z = cvtpk(o[4], o[5]); w.w = cvtpk(o[6], o[7]);
            *(u32x4*)(XC + (size_t)(m0 + r) * 1536 + ch0) = w;
        }
        const bool last = prompt ? (t0 + 32 == TP) : true;
        if (last) {
            float* op = prompt ? a->out + O_LCP + (size_t)(m0 >> 14) * 3 * 1536 + ch0 : a->out + O_LCS + (size_t)(chunk - 1024) * 3 * 1536 + ch0;
#pragma unroll
            for (int i = 0; i < 8; ++i) { op[i] = xm3[i]; op[1536 + i] = xm2[i]; op[3072 + i] = xm1[i]; }
        }
    }
}

__device__ __forceinline__ void phase_scan1(KA a, int gtid, int ngt) {
    const unsigned* LAU = (const unsigned*)(a->ws + WS_LAU); float* CA = (float*)(a->ws + WS_CA); float* CU = (float*)(a->ws + WS_CU);
    for (int idx = gtid; idx < 256 * 768; idx += ngt) {
        const int c = idx / 768, ch = (idx % 768) * 2;
        const unsigned* p = LAU + (size_t)c * 128 * 1536 + ch;
        float L0 = 0.f, L1 = 0.f, U0 = 0.f, U1 = 0.f;
#pragma unroll 16
        for (int r = 0; r < 128; ++r) { const u32x2 w = *(const u32x2*)(p + (size_t)r * 1536);
            const float l0 = bflo(w.x), l1 = bflo(w.y); U0 = fexp2(l0) * U0 + bfhi(w.x); U1 = fexp2(l1) * U1 + bfhi(w.y); L0 += l0; L1 += l1; }
        *(f32x2*)(CA + (size_t)c * 1536 + ch) = (f32x2){fexp2(L0), fexp2(L1)};
        *(f32x2*)(CU + (size_t)c * 1536 + ch) = (f32x2){U0, U1};
    }
}
__device__ __forceinline__ void phase_carry(KA a, int tid, int bid, int G) {
    const float* CA = (const float*)(a->ws + WS_CA); const float* CU = (const float*)(a->ws + WS_CU); float* CIN = (float*)(a->ws + WS_CIN);
    if (tid >= 64) return;
    for (int g = bid * 64 + tid; g < 3072; g += G * 64) {
        const int b = g / 1536, ch = g % 1536; float h = 0.f;
        for (int k0 = 0; k0 < 128; k0 += 16) {
            float ca[16], cu[16];
#pragma unroll
            for (int k = 0; k < 16; ++k) { const size_t o = (size_t)(b * 128 + k0 + k) * 1536 + ch; ca[k] = CA[o]; cu[k] = CU[o]; }
#pragma unroll
            for (int k = 0; k < 16; ++k) { CIN[(size_t)(b * 128 + k0 + k) * 1536 + ch] = h; h = ca[k] * h + cu[k]; }
        }
    }
}
__device__ __forceinline__ void phase_scan3(KA a, int gtid, int ngt) {
    const unsigned* LAU = (const unsigned*)(a->ws + WS_LAU); const float* CIN = (const float*)(a->ws + WS_CIN);
    const bf16r* XBG = (const bf16r*)(a->ws + WS_XBG); bf16r* Z = (bf16r*)(a->ws + WS_XC);
    for (int idx = gtid; idx < (256 + 16) * 768; idx += ngt) {
        const int c = idx / 768, ch = (idx % 768) * 2;
        const bool prompt = c < 256; const int m0 = prompt ? c * 128 : MP + (c - 256) * 32; const int nr = prompt ? 128 : 32;
        float h0, h1;
        if (prompt) { const f32x2 hv = *(const f32x2*)(CIN + (size_t)c * 1536 + ch); h0 = hv.x; h1 = hv.y; }
        else { const f32x2 hv = *(const f32x2*)(a->in[4] + (size_t)(c - 256) * 1536 + ch); h0 = hv.x; h1 = hv.y; }
        const unsigned* p = LAU + (size_t)m0 * 1536 + ch; const bf16r* gp = XBG + (size_t)m0 * 3072 + 1536 + ch; bf16r* zp = Z + (size_t)m0 * 1536 + ch;
#pragma unroll 8
        for (int r = 0; r < nr; ++r) { const u32x2 w = *(const u32x2*)(p + (size_t)r * 1536); const unsigned gw_ = *(const unsigned*)(gp + (size_t)r * 3072);
            h0 = fexp2(bflo(w.x)) * h0 + bfhi(w.x); h1 = fexp2(bflo(w.y)) * h1 + bfhi(w.y);
            *(unsigned*)(zp + (size_t)r * 1536) = cvtpk(h0 * siluf_(bflo(gw_)), h1 * siluf_(bfhi(gw_))); }
        if (prompt) { if ((c & 127) == 127) *(f32x2*)(a->out + O_LHP + (size_t)(c >> 7) * 1536 + ch) = (f32x2){h0, h1}; }
        else *(f32x2*)(a->out + O_LHS + (size_t)(c - 256) * 1536 + ch) = (f32x2){h0, h1};
    }
}

__device__ __forceinline__ float block_excl_scan(float v, float* scr, int tid, int lane, int wid) {
    float inc = v;
#pragma unroll
    for (int o = 1; o < 64; o <<= 1) { const float t = __shfl_up(inc, o); if (lane >= o) inc += t; }
    __syncthreads();
    if (lane == 63) scr[wid] = inc;
    __syncthreads();
    float base = 0.f;
#pragma unroll
    for (int w = 0; w < 8; ++w) base += (w < wid) ? scr[w] : 0.f;
    return base + inc - v;
}

__device__ __forceinline__ void phase_beta(KA a, float* scr, int tid, int lane, int wid, int bid, int G) {
    const float* LFW = (const float*)(a->ws + WS_LFW); float* BETA = (float*)(a->ws + WS_BETA);
    for (int bh = bid; bh < 32; bh += G) {
        const int b = bh >> 4, h = bh & 15; const float* p = LFW + ((size_t)b * TP + (size_t)tid * 32) * 16 + h;
        float v[32]; float s = 0.f;
#pragma unroll
        for (int i = 0; i < 32; ++i) { v[i] = p[i * 16]; s += v[i]; }
        float run = block_excl_scan(s, scr, tid, lane, wid);
        float* o = BETA + (size_t)bh * TP + tid * 32;
#pragma unroll
        for (int i = 0; i < 32; i += 4) { f32x4 w; run += v[i]; w.x = -run * LOG2E; run += v[i + 1]; w.y = -run * LOG2E; run += v[i + 2]; w.z = -run * LOG2E; run += v[i + 3]; w.w = -run * LOG2E; *(f32x4*)(o + i) = w; }
    }
}

typedef short s16x8 __attribute__((ext_vector_type(8)));
typedef float f32x16 __attribute__((ext_vector_type(16)));
__device__ __forceinline__ int crow16(int r, int hi) { return (r & 3) + 8 * (r >> 2) + 4 * hi; }
__device__ __forceinline__ void decode_item(KA a, int s, int h, unsigned char* lds, int tid, int lane, int wid) {
    float* bet = (float*)lds;
    float* scr = (float*)(lds + 16640);
    float* ocomb = (float*)(lds + 20480);
    float* mlc = (float*)(lds + 20480 + 66560);
    const float* LFW = (const float*)(a->ws + WS_LFW);
    const int r32 = lane & 31, hi = lane >> 5;
    __syncthreads();
    {
        float v[9]; float sum = 0.f; const float* lfp_ = a->in[8] + (size_t)s * PAST * 16 + h; const float* lfn_ = LFW + ((size_t)MP + s * 32) * 16 + h;
#pragma unroll
        for (int i = 0; i < 9; ++i) { const int j = tid * 9 + i; float x = 0.f;
            if (j < PAST) x = lfp_[(unsigned)j * 16u]; else if (j < PAST + DSQ) x = lfn_[(unsigned)(j - PAST) * 16u];
            v[i] = x; sum += x; }
        float run = block_excl_scan(sum, scr, tid, lane, wid);
#pragma unroll
        for (int i = 0; i < 9; ++i) { const int j = tid * 9 + i; run += v[i]; if (j < PAST + DSQ) bet[j] = -run * LOG2E; }
    }
    __syncthreads();
    const bf16r* Qb = (const bf16r*)(a->ws + WS_Q) + ((size_t)MP + s * 32 + r32) * 1024 + h * 64 + hi * 8;
    s16x8 qr[4];
#pragma unroll
    for (int d0 = 0; d0 < 4; ++d0) qr[d0] = *(const s16x8*)(Qb + d0 * 16);
    const float* Kc = a->in[6] + (size_t)s * PAST * 1024 + h * 64; const float* Vc = a->in[7] + (size_t)s * PAST * 1024 + h * 64;
    const float* Kn = a->out + O_KS + (size_t)s * 32 * 1024 + h * 64; const float* Vn = a->out + O_VS + (size_t)s * 32 * 1024 + h * 64;
    const int ntile = (wid == 7) ? 17 : 16;
    float mrow = -INFINITY, lrow = 0.f; f32x16 o0, o1;
#pragma unroll
    for (int r = 0; r < 16; ++r) { o0[r] = 0.f; o1[r] = 0.f; }
    f32x4 kraw[8]; float vraw[32];
    const unsigned koff = (unsigned)r32 * 1024u + (unsigned)hi * 8u, voff = (unsigned)hi * 4096u + (unsigned)r32;
#define DEC_LOAD(T) do { const bool nw_ = (T) >= 16; const float* kb_ = nw_ ? Kn : Kc + (size_t)(wid * 512 + (T) * 32) * 1024; const float* vb_ = nw_ ? Vn : Vc + (size_t)(wid * 512 + (T) * 32) * 1024; \
        _Pragma("unroll") for (int d0 = 0; d0 < 4; ++d0) { kraw[2 * d0] = *(const f32x4*)(kb_ + (koff + d0 * 16)); kraw[2 * d0 + 1] = *(const f32x4*)(kb_ + (koff + d0 * 16 + 4)); } \
        _Pragma("unroll") for (int ks = 0; ks < 2; ++ks) _Pragma("unroll") for (int j = 0; j < 8; ++j) { const float* vr_ = vb_ + (16 * ks + 8 * (j >> 2) + (j & 3)) * 1024; \
            vraw[(0 * 2 + ks) * 8 + j] = vr_[voff]; vraw[(1 * 2 + ks) * 8 + j] = vr_[voff + 32u]; } } while (0)
    DEC_LOAD(0);
    for (int t = 0; t < ntile; ++t) {
        s16x8 kf[4], vf[4];
#pragma unroll
        for (int d0 = 0; d0 < 4; ++d0) { u32x4 w; w.x = cvtpk(kraw[2 * d0].x, kraw[2 * d0].y); w.y = cvtpk(kraw[2 * d0].z, kraw[2 * d0].w); w.z = cvtpk(kraw[2 * d0 + 1].x, kraw[2 * d0 + 1].y); w.w = cvtpk(kraw[2 * d0 + 1].z, kraw[2 * d0 + 1].w); kf[d0] = __builtin_bit_cast(s16x8, w); }
#pragma unroll
        for (int q = 0; q < 4; ++q) { u32x4 w; w.x = cvtpk(vraw[q * 8 + 0], vraw[q * 8 + 1]); w.y = cvtpk(vraw[q * 8 + 2], vraw[q * 8 + 3]); w.z = cvtpk(vraw[q * 8 + 4], vraw[q * 8 + 5]); w.w = cvtpk(vraw[q * 8 + 6], vraw[q * 8 + 7]); vf[q] = __builtin_bit_cast(s16x8, w); }
        if (t + 1 < ntile) DEC_LOAD(t + 1);
        f32x16 sc;
#pragma unroll
        for (int r = 0; r < 16; ++r) sc[r] = 0.f;
#pragma unroll
        for (int d0 = 0; d0 < 4; ++d0) sc = __builtin_amdgcn_mfma_f32_32x32x16_bf16(kf[d0], qr[d0], sc, 0, 0, 0);
        const bool nw = t >= 16; const int key0 = nw ? PAST : wid * 512 + t * 32;
        float tmax = -INFINITY;
#pragma unroll
        for (int g = 0; g < 4; ++g) { const f32x4 bb = *(const f32x4*)(bet + key0 + 8 * g + 4 * hi);
#pragma unroll
            for (int j = 0; j < 4; ++j) { float x = sc[4 * g + j] + bb[j]; if (nw && (8 * g + 4 * hi + j) > r32) x = -INFINITY; sc[4 * g + j] = x; tmax = fmaxf(tmax, x); } }
        tmax = fmaxf(tmax, __shfl_xor(tmax, 32));
        const float mnew = fmaxf(mrow, tmax); const float corr = fexp2(mrow - mnew); mrow = mnew;
        float ps = 0.f;
#pragma unroll
        for (int r = 0; r < 16; ++r) { sc[r] = fexp2(sc[r] - mnew); ps += sc[r]; }
        lrow = lrow * corr + ps;
#pragma unroll
        for (int r = 0; r < 16; ++r) { o0[r] *= corr; o1[r] *= corr; }
        s16x8 pf[2];
#pragma unroll
        for (int ks = 0; ks < 2; ++ks) { u32x4 w; w.x = cvtpk(sc[8 * ks + 0], sc[8 * ks + 1]); w.y = cvtpk(sc[8 * ks + 2], sc[8 * ks + 3]); w.z = cvtpk(sc[8 * ks + 4], sc[8 * ks + 5]); w.w = cvtpk(sc[8 * ks + 6], sc[8 * ks + 7]); pf[ks] = __builtin_bit_cast(s16x8, w); }
        o0 = __builtin_amdgcn_mfma_f32_32x32x16_bf16(vf[0], pf[0], o0, 0, 0, 0); o0 = __builtin_amdgcn_mfma_f32_32x32x16_bf16(vf[1], pf[1], o0, 0, 0, 0);
        o1 = __builtin_amdgcn_mfma_f32_32x32x16_bf16(vf[2], pf[0], o1, 0, 0, 0); o1 = __builtin_amdgcn_mfma_f32_32x32x16_bf16(vf[3], pf[1], o1, 0, 0, 0);
    }
#undef DEC_LOAD
    lrow += __shfl_xor(lrow, 32);
    float* oc = ocomb + (size_t)wid * 32 * 65 + r32 * 65;
#pragma unroll
    for (int r = 0; r < 16; ++r) { oc[crow16(r, hi)] = o0[r]; oc[32 + crow16(r, hi)] = o1[r]; }
    if (hi == 0) { mlc[wid * 64 + r32] = mrow; mlc[wid * 64 + 32 + r32] = lrow; }
    __syncthreads();
    {
        const int q = tid >> 4, d4 = (tid & 15) * 4;
        float M = -INFINITY;
#pragma unroll
        for (int w = 0; w < 8; ++w) M = fmaxf(M, mlc[w * 64 + q]);
        float den = 0.f; float num[4] = {0.f, 0.f, 0.f, 0.f};
#pragma unroll
        for (int w = 0; w < 8; ++w) { const float f = fexp2(mlc[w * 64 + q] - M); den += f * mlc[w * 64 + 32 + q]; const float* op = ocomb + (size_t)w * 32 * 65 + q * 65 + d4;
#pragma unroll
            for (int e = 0; e < 4; ++e) num[e] += f * op[e]; }
        const float inv = 1.0f / den;
        const size_t off = ((size_t)MP + s * 32 + q) * 1024 + h * 64 + d4;
        const u32x2 sg = *(const u32x2*)((const bf16r*)(a->ws + WS_SG) + off);
        u32x2 w; w.x = cvtpk(num[0] * inv * bflo(sg.x), num[1] * inv * bfhi(sg.x)); w.y = cvtpk(num[2] * inv * bflo(sg.y), num[3] * inv * bfhi(sg.y));
        *(u32x2*)((bf16r*)(a->ws + WS_Q) + off) = w;
    }
    __syncthreads();
}

constexpr int ATT_BETA_OFF = 86016;
__device__ __forceinline__ void phase_attention(KA a, unsigned char* lds, int tid, int lane, int wid, int bid, int G) {
    using namespace attn_body;
    const bf16* Qp = (const bf16*)(a->ws + WS_Q); const bf16* Kp = (const bf16*)(a->ws + WS_K); const bf16* Vp = (const bf16*)(a->ws + WS_V); const bf16* SGp = (const bf16*)(a->ws + WS_SG);
    const float* BETA = (const float*)(a->ws + WS_BETA);
    float* betl = (float*)(lds + ATT_BETA_OFF);
    int prev_bh = -1;
    const bool bal = (G == 256);
    const int vcu = bal ? (bid % 8) * 32 + bid / 8 : bid;
    const int nit = bal ? 8 : (2048 + G - 1) / G;
    for (int i = 0; i < nit; ++i) {
        int bh, qb;
        if (bal) { const int s = vcu & 7; bh = vcu >> 3; qb = (i & 1) ? (16 * (i >> 1) + 15 - s) : (16 * (i >> 1) + s); }
        else { const int L = i * G + bid; if (L >= 2048) break; bh = L >> 6; qb = 63 - (L & 63); }
        if (bh != prev_bh) {
            __syncthreads();
            const f32x4* src = (const f32x4*)(BETA + (size_t)bh * TP);
#pragma unroll
            for (int j = 0; j < 8; ++j) ((f32x4*)betl)[j * 512 + tid] = src[j * 512 + tid];
            asm volatile("s_waitcnt vmcnt(0) lgkmcnt(0)" ::: "memory");
            __syncthreads();
            prev_bh = bh;
        }
        attn_unit<8>(bh >> 4, bh & 15, qb, Qp, Kp, Vp, (bf16*)Qp, SGp, (lds_fptr)betl, (char*)lds);
    }
    asm volatile("s_waitcnt vmcnt(0) lgkmcnt(0)" ::: "memory");
    __syncthreads();
    for (int it = bid; it < 256; it += G) decode_item(a, it >> 4, it & 15, lds, tid, lane, wid);
}

__global__ void __launch_bounds__(512, 2) fwd_megakernel(Args args_in) {
    extern __shared__ __attribute__((aligned(16))) unsigned char lds[];
    cg::grid_group grid = cg::this_grid();
#define FRESH() KA a = fresh_args(); int tid = threadIdx.x; asm volatile("" : "+v"(tid)); const int lane = tid & 63, wid = __builtin_amdgcn_readfirstlane(tid >> 6), bid = blockIdx.x, G = gridDim.x; \
    const int gtid = bid * 512 + tid, ngt = G * 512, gw = bid * 8 + wid, ngw = G * 8; (void)lane; (void)wid; (void)gtid; (void)ngt; (void)gw; (void)ngw; \
    pg8::bf16_t* H = (pg8::bf16_t*)(a->ws + WS_H); (void)H;

    { FRESH();
    phase_prologue(a, (float*)lds, tid, bid, G);
    }
    grid.sync();
    { FRESH();
    phase_mod_reduce(a, tid, bid, G);
    }
    grid.sync();
    { FRESH();
    phase_rows<0>(a, lane, gw, ngw);
    }
    grid.sync();
    { FRESH();
    {
        pg8::Gemm g{H, (const pg8::bf16_t*)(a->ws + WS_W0IN), MT, 3072, 1024, 1024, 1024, 0}; pg8::StaticOrder S; S.init(MT, 3072, G, bid);
        pg8::EpiStoreBf16 E{(pg8::bf16_t*)(a->ws + WS_XBG), 3072};
        pg8::gemm_phase<pg8::EpiStoreBf16, pg8::StaticOrder, true, true>((LAS unsigned char*)lds, g, S, E);
    }
    }
    grid.sync();
    { FRESH();
    phase_conv(a, gtid, ngt);
    }
    grid.sync();
    { FRESH();
    {
        pg8::Gemm g{(const pg8::bf16_t*)(a->ws + WS_XC), (const pg8::bf16_t*)(a->ws + WS_WG), MT, 3072, 128, 1536, 128, 256}; pg8::StaticOrder S; S.init(MT, 3072, G, bid);
        pg8::EpiGate E{(const pg8::bf16_t*)(a->ws + WS_XC), (unsigned*)(a->ws + WS_LAU), a->in[17], a->in[19], (const float*)(a->ws + WS_SP2)};
        pg8::gemm_phase<pg8::EpiGate, pg8::StaticOrder, true, false>((LAS unsigned char*)lds, g, S, E);
    }
    }
    grid.sync();
    { FRESH();
    phase_scan1(a, gtid, ngt);
    }
    grid.sync();
    { FRESH();
    phase_carry(a, tid, bid, G);
    }
    grid.sync();
    { FRESH();
    phase_scan3(a, gtid, ngt);
    }
    grid.sync();
    { FRESH();
    {
        pg8::Gemm g{(const pg8::bf16_t*)(a->ws + WS_XC), (const pg8::bf16_t*)(a->ws + WS_W0OUT), MT, 1024, 1536, 1536, 1536, 0}; pg8::StaticOrder S; S.init(MT, 1024, G, bid);
        pg8::EpiY E{(float*)(a->ws + WS_Y), (float*)(a->ws + WS_SSQ)};
        pg8::gemm_phase<pg8::EpiY, pg8::StaticOrder, true, true>((LAS unsigned char*)lds, g, S, E);
    }
    }
    grid.sync();
    { FRESH();
    phase_rows<1>(a, lane, gw, ngw);
    }
    grid.sync();
    { FRESH();
    {
        pg8::Gemm g{H, (const pg8::bf16_t*)(a->ws + WS_W1IN), MT, 4352, 1024, 1024, 1024, 0}; pg8::StaticOrder S; S.init(MT, 4352, G, bid);
        pg8::EpiFox E{(pg8::bf16_t*)(a->ws + WS_Q), (pg8::bf16_t*)(a->ws + WS_K), (pg8::bf16_t*)(a->ws + WS_V), (pg8::bf16_t*)(a->ws + WS_SG), a->out, (float*)(a->ws + WS_LFW), a->in[23]};
        pg8::gemm_phase<pg8::EpiFox, pg8::StaticOrder, true, true>((LAS unsigned char*)lds, g, S, E);
    }
    }
    grid.sync();
    { FRESH();
    phase_beta(a, (float*)lds, tid, lane, wid, bid, G);
    }
    grid.sync();
    { FRESH();
    phase_attention(a, lds, tid, lane, wid, bid, G);
    }
    grid.sync();
    { FRESH();
    {
        pg8::Gemm g{(const pg8::bf16_t*)(a->ws + WS_Q), (const pg8::bf16_t*)(a->ws + WS_W1OUT), MT, 1024, 1024, 1024, 1024, 0}; pg8::StaticOrder S; S.init(MT, 1024, G, bid);
        pg8::EpiY E{(float*)(a->ws + WS_Y), (float*)(a->ws + WS_SSQ)};
        pg8::gemm_phase<pg8::EpiY, pg8::StaticOrder, true, true>((LAS unsigned char*)lds, g, S, E);
    }
    }
    grid.sync();
    { FRESH();
    phase_rows<2>(a, lane, gw, ngw);
    }
}

extern "C" void kernel_launch(void* const* d_in, const int* in_sizes, int n_in, void* d_out, int out_size, void* d_ws, size_t ws_size, hipStream_t stream) {
    static int grid_blocks = 0;
    if (grid_blocks == 0) {
        if (n_in != 25 || ws_size < WS_END) { fprintf(stderr, "kernel_launch: unexpected n_in %d / ws %zu\n", n_in, ws_size); grid_blocks = -1; return; }
        int dev = 0, cus = 0, per_cu = 0;
        hipGetDevice(&dev);
        hipDeviceGetAttribute(&cus, hipDeviceAttributeMultiprocessorCount, dev);
        if (hipFuncSetAttribute((const void*)fwd_megakernel, hipFuncAttributeMaxDynamicSharedMemorySize, LDS_BYTES) != hipSuccess) fprintf(stderr, "kernel_launch: hipFuncSetAttribute failed\n");
        if (hipOccupancyMaxActiveBlocksPerMultiprocessor(&per_cu, (const void*)fwd_megakernel, 512, LDS_BYTES) != hipSuccess || per_cu < 1) { fprintf(stderr, "kernel_launch: occupancy query gave %d\n", per_cu); per_cu = 1; }
        (void)hipGetLastError();
        grid_blocks = cus * per_cu;
    }
    if (grid_blocks < 0) return;
    Args a{};
    for (int i = 0; i < 25; ++i) a.in[i] = (const float*)d_in[i];
    a.out = (float*)d_out; a.ws = (unsigned char*)d_ws;
    void* args[] = {&a};
    hipError_t e = hipLaunchCooperativeKernel((void*)fwd_megakernel, dim3(grid_blocks), dim3(512), args, LDS_BYTES, stream);
    if (e != hipSuccess) fprintf(stderr, "cooperative launch failed: %s (grid %d)\n", hipGetErrorString(e), grid_blocks);
}
```
